# Optimizing an MI355X kernel written in HIP

```python
import jax, jax.numpy as jnp
from jax import lax
import numpy as np

D_MODEL = 2048
BATCH = 2
SEQ = 8192
DEPTH = 1
DEC_BATCH = 128
DEC_SEQ = 1
PAST_LEN = 16384
PAGE_SIZE = 128

D_MIX = D_MODEL
D_POOL = D_MIX // 2
POOL_WINDOWS = (2, 4, 8, 16)
N_POOL_GROUPS = len(POOL_WINDOWS)
POOL_GROUP = D_POOL // N_POOL_GROUPS
POOL_STATE = max(POOL_WINDOWS) - 1
HEAD_DIM = 64
D_ATTN = D_MIX - D_POOL
N_HEADS = D_ATTN // HEAD_DIM
N_KV_HEADS = max(1, N_HEADS // 8)
GQA_GROUP = N_HEADS // N_KV_HEADS
KV_W = N_KV_HEADS * HEAD_DIM
WINDOW = 128
BLOCK = 128
ROPE_DIM = HEAD_DIM // 4
ROPE_THETA = 500000.0
EPS = 1e-5
N_IN = 2 * D_POOL + 2 * D_ATTN + 2 * KV_W

kernel_name = 'hybrid_pool_swa_sink_step'


def rms_norm(x, g):
    xf = x.astype(jnp.float32)
    y = xf * lax.rsqrt(jnp.mean(xf * xf, axis=-1, keepdims=True) + EPS)
    return (y * g.astype(jnp.float32)).astype(x.dtype)


def split_cols(z):
    o1 = D_POOL
    o2 = o1 + D_POOL
    o3 = o2 + D_ATTN
    o4 = o3 + KV_W
    o5 = o4 + KV_W
    return z[..., :o1], z[..., o1:o2], z[..., o2:o3], z[..., o3:o4], z[..., o4:o5], z[..., o5:]


def rope_partial(x, pos):
    half = ROPE_DIM // 2
    inv = jnp.power(jnp.float32(ROPE_THETA), -jnp.arange(half, dtype=jnp.float32) * (2.0 / ROPE_DIM))
    ang = pos.astype(jnp.float32)[:, None] * inv[None, :]
    cos = jnp.cos(ang)[None, :, None, :]
    sin = jnp.sin(ang)[None, :, None, :]
    xf = x.astype(jnp.float32)
    x1 = xf[..., :half]
    x2 = xf[..., half:ROPE_DIM]
    out = jnp.concatenate([x1 * cos - x2 * sin, x2 * cos + x1 * sin, xf[..., ROPE_DIM:]], axis=-1)
    return out.astype(x.dtype)


def pool_mix(ext, n_out, pos_out, w_pool, pool_scale):
    B, L, _ = ext.shape
    P = max(POOL_WINDOWS)
    xf = ext.astype(jnp.float32)
    c = jnp.pad(jnp.cumsum(xf, axis=1), ((0, 0), (P, 0), (0, 0)))
    start = L - n_out
    pos = pos_out + jnp.arange(n_out, dtype=jnp.float32)
    parts = []
    for g, w in enumerate(POOL_WINDOWS):
        lo, hi = g * POOL_GROUP, (g + 1) * POOL_GROUP
        win = c[:, P + start:P + L, lo:hi] - c[:, P + start - w:P + L - w, lo:hi]
        cnt = jnp.minimum(pos + 1.0, jnp.float32(w))
        parts.append(win / cnt[None, :, None] - xf[:, start:, lo:hi])
    d = jnp.stack(parts, axis=2)
    y = jnp.einsum('btgc,gcd->btgd', d, w_pool.astype(jnp.float32)).reshape(B, n_out, D_POOL)
    return (y * pool_scale.astype(jnp.float32)).astype(ext.dtype)


def sink_softmax(s, sink):
    sk = sink.astype(jnp.float32).reshape(N_KV_HEADS, GQA_GROUP)[:, :, None, None]
    m = jnp.maximum(jnp.max(s, axis=-1, keepdims=True), sk)
    e = jnp.exp(s - m)
    return e / (jnp.sum(e, axis=-1, keepdims=True) + jnp.exp(sk - m))


def swa_prompt(q, k, v, sink):
    B, S = q.shape[:2]
    nb = S // BLOCK
    qb = q.reshape(B, nb, BLOCK, N_KV_HEADS, GQA_GROUP, HEAD_DIM)
    kb = k.reshape(B, nb, BLOCK, N_KV_HEADS, HEAD_DIM)
    vb = v.reshape(B, nb, BLOCK, N_KV_HEADS, HEAD_DIM)
    pad = ((0, 0), (1, 0), (0, 0), (0, 0), (0, 0))
    kband = jnp.concatenate([jnp.pad(kb, pad)[:, :-1], kb], axis=2)
    vband = jnp.concatenate([jnp.pad(vb, pad)[:, :-1], vb], axis=2)
    s = jnp.einsum('bnqkgd,bnskd->bnkgqs', qb, kband, preferred_element_type=jnp.float32) * (HEAD_DIM ** -0.5)
    qrel = jnp.arange(BLOCK)[:, None] + BLOCK
    krel = jnp.arange(2 * BLOCK)[None, :]
    diff = qrel - krel
    band = (diff >= 0) & (diff <= WINDOW)
    has_prev = (jnp.arange(nb)[:, None, None] > 0) | (krel[None] >= BLOCK)
    mask = band[None] & has_prev
    s = jnp.where(mask[None, :, None, None], s, -jnp.inf)
    p = sink_softmax(s, sink)
    o = jnp.einsum('bnkgqs,bnskd->bnqkgd', p.astype(v.dtype), vband, preferred_element_type=jnp.float32)
    return o.reshape(B, S, D_ATTN).astype(q.dtype)


def swa_decode(q, k_all, v_all, q_pos, k_pos, sink):
    B, T = q.shape[:2]
    qg = q.reshape(B, T, N_KV_HEADS, GQA_GROUP, HEAD_DIM)
    s = jnp.einsum('btkgd,bskd->bkgts', qg, k_all, preferred_element_type=jnp.float32) * (HEAD_DIM ** -0.5)
    diff = q_pos[:, None] - k_pos[None, :]
    mask = (diff >= 0) & (diff <= WINDOW)
    s = jnp.where(mask, s, -jnp.inf)
    p = sink_softmax(s, sink)
    o = jnp.einsum('bkgts,bskd->btkgd', p.astype(v_all.dtype), v_all, preferred_element_type=jnp.float32)
    return o.reshape(B, T, D_ATTN).astype(q.dtype)


def merge_out(pool_o, g_pool, att_o, g_attn, w_out):
    mixed = jnp.concatenate([pool_o * jax.nn.silu(g_pool), att_o * jax.nn.silu(g_attn)], axis=-1)
    return mixed @ w_out


def setup_inputs(seed: int = 0) -> dict:
    key = jax.random.key(seed)
    ks = jax.random.split(key, 12)
    n_buf = min(WINDOW, PAST_LEN)
    f32 = jnp.float32
    nrm = jax.random.normal
    return {
        'x_prompt': nrm(ks[0], (BATCH, SEQ, D_MODEL), f32),
        'x_sample': nrm(ks[1], (DEC_BATCH, DEC_SEQ, D_MODEL), f32),
        'state_pool': nrm(ks[2], (DEPTH, DEC_BATCH, POOL_STATE, D_POOL), f32),
        'state_k_win': nrm(ks[3], (DEPTH, DEC_BATCH, n_buf, N_KV_HEADS, HEAD_DIM), f32),
        'state_v_win': nrm(ks[4], (DEPTH, DEC_BATCH, n_buf, N_KV_HEADS, HEAD_DIM), f32),
        'norm_g': 1.0 + 0.1 * nrm(ks[5], (DEPTH, D_MODEL), f32),
        'w_in': nrm(ks[6], (DEPTH, D_MODEL, N_IN), f32) * (D_MODEL ** -0.5),
        'w_pool': nrm(ks[7], (DEPTH, N_POOL_GROUPS, POOL_GROUP, POOL_GROUP), f32) * (POOL_GROUP ** -0.5),
        'pool_scale': 1.0 + 0.1 * nrm(ks[8], (DEPTH, D_POOL), f32),
        'attn_sinks': nrm(ks[9], (DEPTH, N_HEADS), f32),
        'w_out': nrm(ks[10], (DEPTH, D_MIX, D_MODEL), f32) * (D_MIX ** -0.5),
        'final_norm_g': 1.0 + 0.1 * nrm(ks[11], (D_MODEL,), f32),
    }


def reference(x_prompt, x_sample, state_pool, state_k_win, state_v_win, norm_g, w_in, w_pool,
              pool_scale, attn_sinks, w_out, final_norm_g):
    B, S = x_prompt.shape[:2]
    DB, T = x_sample.shape[:2]
    n_buf = state_k_win.shape[2]
    pos_p = jnp.arange(S, dtype=jnp.int32)
    pos_s = PAST_LEN + jnp.arange(T, dtype=jnp.int32)
    kpos_s = PAST_LEN - n_buf + jnp.arange(n_buf + T, dtype=jnp.int32)
    xp, xs = x_prompt, x_sample
    pp_pool, pp_k, pp_v, ps_pool, ps_k, ps_v = [], [], [], [], [], []
    for l in range(DEPTH):
        h = rms_norm(xp, norm_g[l])
        u, gp, q, k, v, ga = split_cols(h @ w_in[l])
        pool_o = pool_mix(u, S, 0, w_pool[l], pool_scale[l])
        q = rope_partial(q.reshape(B, S, N_HEADS, HEAD_DIM), pos_p)
        k = rope_partial(k.reshape(B, S, N_KV_HEADS, HEAD_DIM), pos_p)
        v = v.reshape(B, S, N_KV_HEADS, HEAD_DIM)
        att = swa_prompt(q, k, v, attn_sinks[l])
        xp = xp + merge_out(pool_o, gp, att, ga, w_out[l])
        pp_pool.append(u[:, S - POOL_STATE:])
        pp_k.append(k[:, S - WINDOW:])
        pp_v.append(v[:, S - WINDOW:])
        h = rms_norm(xs, norm_g[l])
        u, gp, q, k, v, ga = split_cols(h @ w_in[l])
        ext = jnp.concatenate([state_pool[l].astype(u.dtype), u], axis=1)
        pool_o = pool_mix(ext, T, PAST_LEN, w_pool[l], pool_scale[l])
        q = rope_partial(q.reshape(DB, T, N_HEADS, HEAD_DIM), pos_s)
        k = rope_partial(k.reshape(DB, T, N_KV_HEADS, HEAD_DIM), pos_s)
        v = v.reshape(DB, T, N_KV_HEADS, HEAD_DIM)
        k_all = jnp.concatenate([state_k_win[l].astype(k.dtype), k], axis=1)
        v_all = jnp.concatenate([state_v_win[l].astype(v.dtype), v], axis=1)
        att = swa_decode(q, k_all, v_all, pos_s, kpos_s, attn_sinks[l])
        xs = xs + merge_out(pool_o, gp, att, ga, w_out[l])
        ps_pool.append(ext[:, ext.shape[1] - POOL_STATE:])
        ps_k.append(k_all[:, k_all.shape[1] - n_buf:])
        ps_v.append(v_all[:, v_all.shape[1] - n_buf:])
    y_prompt = rms_norm(xp, final_norm_g)
    y_sample = rms_norm(xs, final_norm_g)
    new_pool_prompt = jnp.stack(pp_pool, axis=0)
    new_k_prompt = jnp.stack(pp_k, axis=0)
    new_v_prompt = jnp.stack(pp_v, axis=0)
    new_pool_sample = jnp.stack(ps_pool, axis=0)
    new_k_sample = jnp.stack(ps_k, axis=0)
    new_v_sample = jnp.stack(ps_v, axis=0)
    return (y_prompt, y_sample, new_pool_prompt, new_k_prompt, new_v_prompt, new_pool_sample, new_k_sample, new_v_sample)
```

```cpp
#include <hip/hip_runtime.h>
#include <hip/hip_cooperative_groups.h>
#include <cstdio>
namespace cg = cooperative_groups;

#ifndef MK_N_LAUNCHES
#define MK_N_LAUNCHES 1
#endif

#define LAS __attribute__((address_space(3)))
typedef unsigned short bf16_t;
typedef short bf16x8 __attribute__((ext_vector_type(8)));
typedef float f32x2 __attribute__((ext_vector_type(2)));
typedef float f32x4 __attribute__((ext_vector_type(4)));
typedef float f32x16 __attribute__((ext_vector_type(16)));
typedef unsigned u32x2 __attribute__((ext_vector_type(2)));
typedef unsigned u32x4 __attribute__((ext_vector_type(4)));
typedef __bf16 bf16x2_t __attribute__((ext_vector_type(2)));

constexpr int DM = 2048, SEQ = 8192, NB = 2, MP = NB * SEQ  , MS = 128  ;
constexpr int MTOT = MP + MS  , MPAD = MP + 256  ;
constexpr int NIN = 4352, DPOOL = 1024, HD = 64, NH = 16;
constexpr int O_U = 0, O_GP = 1024, O_Q = 2048, O_K = 3072, O_V = 3200, O_GA = 3328;
constexpr float EPS = 1e-5f, LOG2E = 1.4426950408889634f;
constexpr size_t OUT_YP = 0, OUT_YS = 33554432, OUT_PP = 33816576, OUT_KP = 33847296, OUT_VP = 33880064, OUT_PS = 33912832, OUT_KS = 35878912, OUT_VS = 37976064;
constexpr size_t MiB = 1u << 20;
constexpr size_t WS_WIN_T = 2 * MiB, WS_WOUT_T = 20 * MiB, WS_WPOOL_T = 28 * MiB, WS_ROPE = 29 * MiB, WS_PART = 30 * MiB, WS_PARTS = 33 * MiB,
                 WS_H = 34 * MiB, WS_Z = 100 * MiB, WS_D = 240 * MiB, WS_MIX = 274 * MiB, WS_END = 340 * MiB;
constexpr int LDS_BYTES = 147456;

struct Params {
    const float *xp, *xs, *spool, *sk, *sv, *norm_g, *w_in, *w_pool, *pscale, *sinks, *w_out, *fnorm_g;
    float* out; unsigned char* ws; int ph_lo, ph_hi;
};

__device__ __forceinline__ unsigned pk2(float lo, float hi) { f32x2 v = {lo, hi}; bf16x2_t r = __builtin_convertvector(v, bf16x2_t); return __builtin_bit_cast(unsigned, r); }
__device__ __forceinline__ float bflo(unsigned w) { return __uint_as_float(w << 16); }
__device__ __forceinline__ float bfhi(unsigned w) { return __uint_as_float(w & 0xffff0000u); }
__device__ __forceinline__ float bf1(bf16_t b) { return __uint_as_float((unsigned)b << 16); }
__device__ __forceinline__ float silu(float x) { return x * __builtin_amdgcn_rcpf(1.0f + __builtin_amdgcn_exp2f(-x * LOG2E)); }
__device__ __forceinline__ float wave_sum(float v) {
#pragma unroll
    for (int o = 1; o < 64; o <<= 1) v += __shfl_xor(v, o);
    return v;
}
__device__ __forceinline__ float wave_max(float v) {
#pragma unroll
    for (int o = 1; o < 64; o <<= 1) v = fmaxf(v, __shfl_xor(v, o));
    return v;
}
__device__ __forceinline__ void unpack8(const u32x4 v, float (&f)[8]) {
    f[0] = bflo(v.x); f[1] = bfhi(v.x); f[2] = bflo(v.y); f[3] = bfhi(v.y); f[4] = bflo(v.z); f[5] = bfhi(v.z); f[6] = bflo(v.w); f[7] = bfhi(v.w);
}
__device__ __forceinline__ u32x4 pack8(const float (&f)[8]) { u32x4 r; r.x = pk2(f[0], f[1]); r.y = pk2(f[2], f[3]); r.z = pk2(f[4], f[5]); r.w = pk2(f[6], f[7]); return r; }

namespace pg8 {
constexpr int BM = 256, BK = 64, HALF = 128, HTB = HALF * BK * 2, NXCD = 8, WGM = 8;
__device__ __forceinline__ int lds_byte(int r, int c) { const int st = (r >> 4) * 2 + (c >> 5), rr = r & 15, cc = c & 31, ob = rr * 64 + cc * 2; return st * 1024 + (ob ^ (((ob >> 9) & 1) << 5)); }
__device__ __forceinline__ void stage_rc(int b, int& R, int& C) { const int st = b / 1024, sb = b % 1024, swz = sb ^ (((sb >> 9) & 1) << 5); R = (st >> 1) * 16 + swz / 64; C = (st & 1) * 32 + (swz % 64) / 2; }
__device__ __forceinline__ int perm32(int rho) { const int n = rho >> 4, i = rho & 15; return 8 * (i >> 2) + 4 * n + (i & 3); }
struct Unit { int pm, pn; };
struct Gemm { const bf16_t* A; const bf16_t* Bt; int M, N, K, lda, ldb, a_koff; };
struct StaticOrder {
    int nM, nN, nwg, G, c;
    __device__ void init(int M, int N, int G_, int c_) { nM = M / BM; nN = N / BM; nwg = nM * nN; G = G_; c = c_; }
    __device__ bool next(int i, Unit& u) const {
        const long L = (long)i * G + c; if (L >= nwg) return false;
        int wgid = (int)L; { const int q = nwg / NXCD, r = nwg % NXCD, xcd = wgid % NXCD, off = wgid / NXCD; wgid = (xcd < r ? xcd * (q + 1) : r * (q + 1) + (xcd - r) * q) + off; }
        const int nig = WGM * nN, gid = wgid / nig, fm = gid * WGM, gsz = (nM - fm) < WGM ? (nM - fm) : WGM;
        u.pm = fm + ((wgid % nig) % gsz); u.pn = (wgid % nig) / gsz; return true;
    }
};

template <class Epi>
__device__ __forceinline__ void gemm_phase(LAS unsigned char* lds, const Gemm g, const StaticOrder& S, const Epi& E) {
    const int tid = threadIdx.x, wid = __builtin_amdgcn_readfirstlane(tid >> 6), lane = tid & 63, wr = wid >> 2, wc = wid & 3, fr = lane & 15, fq = lane >> 4;
    const int nt = g.K / BK;
    unsigned voffA[2], voffB[2];
#pragma unroll
    for (int i = 0; i < 2; ++i) { int R, C; stage_rc(tid * 16 + i * 8192, R, C); const int Rb = Epi::PERM ? ((R & ~31) + perm32(R & 31)) : R;
        voffA[i] = (unsigned)(R * g.lda + C) * 2u; voffB[i] = (unsigned)(Rb * g.ldb + C) * 2u; }
    const size_t kstep = (size_t)(BK * 2);
    const size_t hstepA = (size_t)HALF * g.lda * 2, hstepB = (size_t)HALF * g.ldb * 2;
    const size_t tstepA = 2 * hstepA, tstepB = 2 * hstepB;
    const unsigned ldsw = (unsigned)wid * 1024u;
    const int aoff = lds_byte(wr * 64 + fr, fq * 8), boff = lds_byte(wc * 32 + fr, fq * 8);
#define PG8_SA(b, h) (((b) * 2 + (h)) * HTB)
#define PG8_SB(b, h) ((4 + (b) * 2 + (h)) * HTB)
#define PG8_STAGE(bufoff, gbase, voff) do { _Pragma("unroll") for (int _i = 0; _i < 2; ++_i) \
        __builtin_amdgcn_global_load_lds((const unsigned*)((const char*)(gbase) + (voff)[_i]), (LAS unsigned*)(lds + (bufoff) + ldsw + _i * 8192), 16, 0, 0); } while (0)
#define PG8_LDA(dst, b, h) do { _Pragma("unroll") for (int m = 0; m < 4; ++m) _Pragma("unroll") for (int k = 0; k < 2; ++k) dst[m][k] = *(const LAS bf16x8*)(lds + PG8_SA(b, h) + aoff + m * 2048 + k * 1024); } while (0)
#define PG8_LDB(dst, b, h) do { _Pragma("unroll") for (int n = 0; n < 2; ++n) _Pragma("unroll") for (int k = 0; k < 2; ++k) dst[n][k] = *(const LAS bf16x8*)(lds + PG8_SB(b, h) + boff + n * 2048 + k * 1024); } while (0)
#define PG8_MMA(ai, bj, At, Bt) do { __builtin_amdgcn_s_setprio(1); _Pragma("unroll") for (int m = 0; m < 4; ++m) _Pragma("unroll") for (int n = 0; n < 2; ++n) _Pragma("unroll") for (int k = 0; k < 2; ++k) \
        acc[ai][bj][m][n] = __builtin_amdgcn_mfma_f32_16x16x32_bf16(Bt[n][k], At[m][k], acc[ai][bj][m][n], 0, 0, 0); __builtin_amdgcn_s_setprio(0); } while (0)
#define PG8_WAIT_V(n) asm volatile("s_waitcnt vmcnt(" #n ")" ::: "memory")
#define PG8_WAIT_L(n) asm volatile("s_waitcnt lgkmcnt(" #n ")" ::: "memory")
#define PG8_BAR __builtin_amdgcn_s_barrier()
#define PG8_SCHED __builtin_amdgcn_sched_barrier(0)
    Unit cur, nxt; int ui = 0;
    if (!S.next(0, cur)) return;
    f32x4 acc[2][2][4][2];
#pragma unroll
    for (int a = 0; a < 2; ++a)
#pragma unroll
        for (int b = 0; b < 2; ++b)
#pragma unroll
            for (int m = 0; m < 4; ++m)
#pragma unroll
                for (int n = 0; n < 2; ++n) acc[a][b][m][n] = (f32x4){0.f, 0.f, 0.f, 0.f};
    bf16x8 At[4][2], B0[2][2], B1[2][2];
    const char* cA = (const char*)g.A + (size_t)cur.pm * tstepA + (size_t)cur.pn * g.a_koff * 2; const char* cB = (const char*)g.Bt + (size_t)cur.pn * tstepB;
    PG8_STAGE(PG8_SB(0, 0), cB, voffB); PG8_STAGE(PG8_SA(0, 0), cA, voffA); PG8_STAGE(PG8_SB(0, 1), cB + hstepB, voffB); PG8_STAGE(PG8_SA(0, 1), cA + hstepA, voffA);
    if (wr == 1) PG8_BAR;
    PG8_WAIT_V(4); PG8_BAR;
    PG8_STAGE(PG8_SB(1, 0), cB + kstep, voffB); PG8_STAGE(PG8_SA(1, 0), cA + kstep, voffA); PG8_STAGE(PG8_SB(1, 1), cB + hstepB + kstep, voffB);
    PG8_WAIT_V(6); PG8_BAR;
    for (;;) {
        const bool has_next = S.next(ui + 1, nxt);
        const char* nA = has_next ? (const char*)g.A + (size_t)nxt.pm * tstepA + (size_t)nxt.pn * g.a_koff * 2 : cA; const char* nB = has_next ? (const char*)g.Bt + (size_t)nxt.pn * tstepB : cB;
#pragma unroll 1
        for (int t = 0; t < nt; t += 2) {
            const bool last = (t == nt - 2);
            const char* a1 = cA + (size_t)(t + 1) * kstep;
            const char* a2 = last ? nA : cA + (size_t)(t + 2) * kstep; const char* b2 = last ? nB : cB + (size_t)(t + 2) * kstep;
            const char* a3 = a2 + kstep; const char* b3 = b2 + kstep;
            PG8_LDB(B0, 0, 0); PG8_SCHED; PG8_LDA(At, 0, 0); PG8_STAGE(PG8_SA(1, 1), a1 + hstepA, voffA);
            PG8_WAIT_L(8); PG8_BAR; PG8_WAIT_L(0); PG8_MMA(0, 0, At, B0); PG8_BAR; PG8_SCHED;
            PG8_LDB(B1, 0, 1); PG8_STAGE(PG8_SB(0, 0), b2, voffB);
            PG8_BAR; PG8_WAIT_L(0); PG8_MMA(0, 1, At, B1); PG8_BAR;
            PG8_LDA(At, 0, 1); PG8_STAGE(PG8_SA(0, 0), a2, voffA);
            PG8_BAR; PG8_WAIT_L(0); PG8_MMA(1, 0, At, B0); PG8_BAR; PG8_SCHED;
            PG8_STAGE(PG8_SB(0, 1), b2 + hstepB, voffB);
            PG8_WAIT_V(6); PG8_BAR; PG8_MMA(1, 1, At, B1); PG8_BAR;
            PG8_LDB(B0, 1, 0); PG8_SCHED; PG8_LDA(At, 1, 0); PG8_STAGE(PG8_SA(0, 1), a2 + hstepA, voffA);
            PG8_WAIT_L(8); PG8_BAR; PG8_WAIT_L(0); PG8_MMA(0, 0, At, B0); PG8_BAR; PG8_SCHED;
            PG8_LDB(B1, 1, 1); PG8_STAGE(PG8_SB(1, 0), b3, voffB);
            PG8_BAR; PG8_WAIT_L(0); PG8_MMA(0, 1, At, B1); PG8_BAR;
            PG8_LDA(At, 1, 1); PG8_STAGE(PG8_SA(1, 0), a3, voffA);
            PG8_BAR; PG8_WAIT_L(0); PG8_MMA(1, 0, At, B0); PG8_BAR; PG8_SCHED;
            PG8_STAGE(PG8_SB(1, 1), b3 + hstepB, voffB);
            PG8_WAIT_V(6); PG8_BAR; PG8_MMA(1, 1, At, B1); PG8_BAR;
        }
        E(acc, cur, wr, wc, fr, fq);
        if (!has_next) break;
#pragma unroll
        for (int a = 0; a < 2; ++a)
#pragma unroll
            for (int b = 0; b < 2; ++b)
#pragma unroll
                for (int m = 0; m < 4; ++m)
#pragma unroll
                    for (int n = 0; n < 2; ++n) acc[a][b][m][n] = (f32x4){0.f, 0.f, 0.f, 0.f};
        cur = nxt; cA = nA; cB = nB; ++ui;
    }
    PG8_WAIT_V(0);
    if (wr == 0) PG8_BAR;
    PG8_BAR;
#undef PG8_SA
#undef PG8_SB
#undef PG8_STAGE
#undef PG8_LDA
#undef PG8_LDB
#undef PG8_MMA
#undef PG8_WAIT_V
#undef PG8_WAIT_L
#undef PG8_BAR
#undef PG8_SCHED
}
}

struct EpiZ {
    static constexpr bool PERM = true;
    bf16_t* O;
    __device__ __forceinline__ void operator()(const f32x4 (&acc)[2][2][4][2], const pg8::Unit& u, int wr, int wc, int fr, int fq) const {
        const int row0 = u.pm * 256 + wr * 64 + fr, col0 = u.pn * 256 + wc * 32 + 8 * fq;
#pragma unroll
        for (int ai = 0; ai < 2; ++ai)
#pragma unroll
            for (int m = 0; m < 4; ++m) { bf16_t* rowp = O + (size_t)(row0 + ai * 128 + m * 16) * NIN + col0;
#pragma unroll
                for (int bj = 0; bj < 2; ++bj) { const f32x4 v0 = acc[ai][bj][m][0], v1 = acc[ai][bj][m][1];
                    u32x4 w; w.x = pk2(v0[0], v0[1]); w.y = pk2(v0[2], v0[3]); w.z = pk2(v1[0], v1[1]); w.w = pk2(v1[2], v1[3]);
                    *(u32x4*)(rowp + bj * 128) = w; } }
    }
};
struct EpiPool {
    static constexpr bool PERM = true;
    const bf16_t* z; bf16_t* mixed; const float* pscale;
    __device__ __forceinline__ void operator()(const f32x4 (&acc)[2][2][4][2], const pg8::Unit& u, int wr, int wc, int fr, int fq) const {
        const int row0 = u.pm * 256 + wr * 64 + fr, col0 = u.pn * 256 + wc * 32 + 8 * fq;
        f32x4 sc[2][2];
#pragma unroll
        for (int bj = 0; bj < 2; ++bj)
#pragma unroll
            for (int n = 0; n < 2; ++n) sc[bj][n] = *(const f32x4*)(pscale + col0 + bj * 128 + 4 * n);
#pragma unroll
        for (int ai = 0; ai < 2; ++ai)
#pragma unroll
            for (int m = 0; m < 4; ++m) { const size_t row = (size_t)(row0 + ai * 128 + m * 16);
#pragma unroll
                for (int bj = 0; bj < 2; ++bj) { const int c = col0 + bj * 128;
                    const u32x4 gw = *(const u32x4*)(z + row * NIN + O_GP + c); float gp[8]; unpack8(gw, gp);
                    const f32x4 v0 = acc[ai][bj][m][0] * sc[bj][0], v1 = acc[ai][bj][m][1] * sc[bj][1];
                    float o[8];
#pragma unroll
                    for (int j = 0; j < 4; ++j) { o[j] = v0[j] * silu(gp[j]); o[4 + j] = v1[j] * silu(gp[4 + j]); }
                    *(u32x4*)(mixed + row * DM + c) = pack8(o); }
                asm volatile("" ::: "memory"); }
    }
};
struct EpiOut {
    static constexpr bool PERM = false;
    const float* x; float* out; float* part;
    __device__ __forceinline__ void operator()(const f32x4 (&acc)[2][2][4][2], const pg8::Unit& u, int wr, int wc, int fr, int fq) const {
        const int row0 = u.pm * 256 + wr * 64 + fr, col0 = u.pn * 256 + wc * 32 + 4 * fq;
#pragma unroll
        for (int ai = 0; ai < 2; ++ai)
#pragma unroll
            for (int m = 0; m < 4; ++m) { const size_t row = (size_t)(row0 + ai * 128 + m * 16); float ss = 0.f;
#pragma unroll
                for (int bj = 0; bj < 2; ++bj)
#pragma unroll
                    for (int n = 0; n < 2; ++n) { const size_t off = row * DM + col0 + bj * 128 + n * 16;
                        const f32x4 v = acc[ai][bj][m][n] + *(const f32x4*)(x + off); *(f32x4*)(out + off) = v;
                        ss += (v[0] * v[0] + v[1] * v[1]) + (v[2] * v[2] + v[3] * v[3]); }
                ss += __shfl_xor(ss, 16); ss += __shfl_xor(ss, 32);
                if (fq == 0) part[row * 32 + u.pn * 4 + wc] = ss; }
    }
};

__device__ __forceinline__ void p0_transpose_item(const float* W, int K, int N, bf16_t* WT, LAS float* scr, int item, int lane) {
    const int nblk = N / 32, kb = item / nblk, nb = item % nblk, k0 = 64 * kb, n0 = 32 * nb;
#pragma unroll 8
    for (int i = 0; i < 32; ++i) { const int kk = 2 * i + (lane >> 5); scr[kk * 33 + (lane & 31)] = W[(size_t)(k0 + kk) * N + n0 + (lane & 31)]; }
    asm volatile("s_waitcnt lgkmcnt(0)" ::: "memory");
    const int c = lane & 7;
#pragma unroll
    for (int j = 0; j < 4; ++j) { const int n = (lane >> 3) + 8 * j; const LAS float* s = scr + (8 * c) * 33 + n;
        u32x4 o; o.x = pk2(s[0 * 33], s[1 * 33]); o.y = pk2(s[2 * 33], s[3 * 33]); o.z = pk2(s[4 * 33], s[5 * 33]); o.w = pk2(s[6 * 33], s[7 * 33]);
        *(u32x4*)(WT + (size_t)(n0 + n) * K + k0 + 8 * c) = o; }
    asm volatile("s_waitcnt lgkmcnt(0)" ::: "memory");
}
__device__ __forceinline__ void phase0(const Params& p, LAS unsigned char* lds) {
    const int tid = threadIdx.x, lane = tid & 63, wave = tid >> 6;
    const int gw = blockIdx.x * 8 + wave, NGW = gridDim.x * 8;
    unsigned char* ws = p.ws;
    bf16_t* win_t = (bf16_t*)(ws + WS_WIN_T); bf16_t* wout_t = (bf16_t*)(ws + WS_WOUT_T); bf16_t* wpool_t = (bf16_t*)(ws + WS_WPOOL_T);
    bf16_t* h = (bf16_t*)(ws + WS_H); float* rope = (float*)(ws + WS_ROPE);
    LAS float* scr = (LAS float*)(lds + wave * 16384);
    constexpr int I_IN = (DM / 64) * (NIN / 32), I_OUT = (DM / 64) * (DM / 32), I_PG = (256 / 64) * (256 / 32), NITEMS = I_IN + I_OUT + 4 * I_PG;
    for (int it = gw; it < NITEMS; it += NGW) {
        int r = it;
        if (r < I_IN) { p0_transpose_item(p.w_in, DM, NIN, win_t, scr, r, lane); continue; } r -= I_IN;
        if (r < I_OUT) { p0_transpose_item(p.w_out, DM, DM, wout_t, scr, r, lane); continue; } r -= I_OUT;
        const int g = r / I_PG; r -= g * I_PG;
        p0_transpose_item(p.w_pool + (size_t)g * 65536, 256, 256, wpool_t + (size_t)g * 65536, scr, r, lane);
    }
    for (int m = gw; m < MTOT; m += NGW) {
        const float* xr = m < MP ? p.xp + (size_t)m * DM : p.xs + (size_t)(m - MP) * DM;
        f32x4 v[8]; float s = 0.f;
#pragma unroll
        for (int j = 0; j < 8; ++j) { v[j] = ((const f32x4*)xr)[64 * j + lane]; s += (v[j][0] * v[j][0] + v[j][1] * v[j][1]) + (v[j][2] * v[j][2] + v[j][3] * v[j][3]); }
        const float rstd = 1.0f / sqrtf(wave_sum(s) * (1.0f / DM) + EPS);
        u32x2* o = (u32x2*)(h + (size_t)m * DM);
#pragma unroll
        for (int j = 0; j < 8; ++j) { const f32x4 g4 = ((const f32x4*)p.norm_g)[64 * j + lane]; u32x2 w; w.x = pk2(v[j][0] * rstd * g4[0], v[j][1] * rstd * g4[1]); w.y = pk2(v[j][2] * rstd * g4[2], v[j][3] * rstd * g4[3]); o[64 * j + lane] = w; }
    }
    { u32x4* hz = (u32x4*)(h + (size_t)MTOT * DM); const int nvec = (MPAD - MTOT) * DM / 8;
      for (int i = blockIdx.x * 512 + tid; i < nvec; i += gridDim.x * 512) hz[i] = (u32x4){0u, 0u, 0u, 0u}; }
    for (int i = blockIdx.x * 512 + tid; i < 8193 * 8; i += gridDim.x * 512) {
        const int e = i >> 3, f = i & 7; const int pos = e < 8192 ? e : 16384;
        const float invs[8] = {1.0f, 0.1939227432012558f, 0.03760603070259094f, 0.007292664609849453f, 0.0014142135623842478f, 0.00027424818836152554f, 5.3182957344688475e-05f, 1.0313385246263351e-05f};
        float inv = invs[0];
#pragma unroll
        for (int q = 1; q < 8; ++q) inv = (f == q) ? invs[q] : inv;
        const float ang = (float)pos * inv;
        const double t = (double)ang * 0.15915494309189535; const float fr = (float)(t - __builtin_rint(t));
        rope[e * 16 + f] = __builtin_amdgcn_cosf(fr); rope[e * 16 + 8 + f] = __builtin_amdgcn_sinf(fr);
    }
}

__device__ __forceinline__ void pool_d_unit(const bf16_t* z, bf16_t* dpool, int pm, int g) {
    const int tid = threadIdx.x, c0 = 256 * g + 8 * (tid & 31), seg = tid >> 5, w = 2 << g;
    const int t0 = 256 * pm + 16 * seg, tp0 = t0 & (SEQ - 1);
    float sum[8];
#pragma unroll
    for (int j = 0; j < 8; ++j) sum[j] = 0.f;
    for (int i = 1; i < w; ++i) if (tp0 - i >= 0) { float f[8]; unpack8(*(const u32x4*)(z + (size_t)(t0 - i) * NIN + O_U + c0), f);
#pragma unroll
        for (int j = 0; j < 8; ++j) sum[j] += f[j]; }
    for (int r = 0; r < 16; ++r) { const int t = t0 + r, tp = tp0 + r;
        float cur[8]; unpack8(*(const u32x4*)(z + (size_t)t * NIN + O_U + c0), cur);
        const float rc = 1.0f / (float)((tp + 1) < w ? (tp + 1) : w);
        float o[8];
#pragma unroll
        for (int j = 0; j < 8; ++j) { sum[j] += cur[j]; o[j] = sum[j] * rc - cur[j]; }
        *(u32x4*)(dpool + (size_t)t * DPOOL + c0) = pack8(o);
        if (tp - (w - 1) >= 0) { float f[8]; unpack8(*(const u32x4*)(z + (size_t)(t - (w - 1)) * NIN + O_U + c0), f);
#pragma unroll
            for (int j = 0; j < 8; ++j) sum[j] -= f[j]; }
    }
}

__device__ __forceinline__ void attn_item(const Params& p, LAS unsigned char* lds, int item) {
    const int tid = threadIdx.x, lane = tid & 63, wave = __builtin_amdgcn_readfirstlane(tid >> 6);
    const int kvh = item & 1, n = (item >> 1) & 63, b = item >> 7;
    const bf16_t* z = (const bf16_t*)(p.ws + WS_Z); const float* rope = (const float*)(p.ws + WS_ROPE); bf16_t* mixed = (bf16_t*)(p.ws + WS_MIX);
    LAS bf16_t* Ks = (LAS bf16_t*)lds;
    LAS bf16_t* Vt = (LAS bf16_t*)(lds + 36864);
    const size_t rowbase = (size_t)b * SEQ;
    {
        const int key = tid >> 1, half = tid & 1, tpos = n * 128 - 128 + key;
        u32x4 v[4];
#pragma unroll
        for (int i = 0; i < 4; ++i) v[i] = (u32x4){0u, 0u, 0u, 0u};
        if (tpos >= 0) {
            const bf16_t* src = z + (rowbase + tpos) * NIN + O_K + kvh * 64 + half * 32;
#pragma unroll
            for (int i = 0; i < 4; ++i) v[i] = ((const u32x4*)src)[i];
            const bool wr_out = (n == 63 && key >= 128);
            float* ko = p.out + OUT_KP + ((size_t)(b * 128 + (key - 128)) * 2 + kvh) * 64 + half * 32;
            if (half == 0) {
                float x1[8], x2[8], r1[8], r2[8]; unpack8(v[0], x1); unpack8(v[1], x2);
                const f32x4 c0 = *(const f32x4*)(rope + tpos * 16), c1 = *(const f32x4*)(rope + tpos * 16 + 4), s0 = *(const f32x4*)(rope + tpos * 16 + 8), s1 = *(const f32x4*)(rope + tpos * 16 + 12);
#pragma unroll
                for (int i = 0; i < 8; ++i) { const float c = i < 4 ? c0[i & 3] : c1[i & 3], s = i < 4 ? s0[i & 3] : s1[i & 3]; r1[i] = x1[i] * c - x2[i] * s; r2[i] = x2[i] * c + x1[i] * s; }
                v[0] = pack8(r1); v[1] = pack8(r2);
                if (wr_out) { *(f32x4*)(ko) = (f32x4){r1[0], r1[1], r1[2], r1[3]}; *(f32x4*)(ko + 4) = (f32x4){r1[4], r1[5], r1[6], r1[7]};
                              *(f32x4*)(ko + 8) = (f32x4){r2[0], r2[1], r2[2], r2[3]}; *(f32x4*)(ko + 12) = (f32x4){r2[4], r2[5], r2[6], r2[7]}; }
            } else if (wr_out) {
#pragma unroll
                for (int i = 0; i < 2; ++i) { float f[8]; unpack8(v[i], f); *(f32x4*)(ko + 8 * i) = (f32x4){f[0], f[1], f[2], f[3]}; *(f32x4*)(ko + 8 * i + 4) = (f32x4){f[4], f[5], f[6], f[7]}; }
            }
            if (wr_out) {
#pragma unroll
                for (int i = 2; i < 4; ++i) { float f[8]; unpack8(v[i], f); *(f32x4*)(ko + 8 * i) = (f32x4){f[0], f[1], f[2], f[3]}; *(f32x4*)(ko + 8 * i + 4) = (f32x4){f[4], f[5], f[6], f[7]}; }
            }
        }
#pragma unroll
        for (int i = 0; i < 4; ++i) *(LAS u32x4*)(Ks + key * 72 + half * 32 + 8 * i) = v[i];
    }
    {
        const int pair = tid & 127, dq = tid >> 7, key0 = 2 * pair, tpos0 = n * 128 - 128 + key0;
        u32x4 a[2], bb[2];
#pragma unroll
        for (int i = 0; i < 2; ++i) { a[i] = (u32x4){0u, 0u, 0u, 0u}; bb[i] = (u32x4){0u, 0u, 0u, 0u}; }
        if (tpos0 >= 0) {
            const bf16_t* src = z + (rowbase + tpos0) * NIN + O_V + kvh * 64 + dq * 16;
#pragma unroll
            for (int i = 0; i < 2; ++i) { a[i] = ((const u32x4*)src)[i]; bb[i] = ((const u32x4*)(src + NIN))[i]; }
            if (n == 63 && key0 >= 128) {
                float* vo = p.out + OUT_VP + ((size_t)(b * 128 + (key0 - 128)) * 2 + kvh) * 64 + dq * 16;
#pragma unroll
                for (int i = 0; i < 2; ++i) { float f[8]; unpack8(a[i], f); *(f32x4*)(vo + 8 * i) = (f32x4){f[0], f[1], f[2], f[3]}; *(f32x4*)(vo + 8 * i + 4) = (f32x4){f[4], f[5], f[6], f[7]};
                    unpack8(bb[i], f); *(f32x4*)(vo + 128 + 8 * i) = (f32x4){f[0], f[1], f[2], f[3]}; *(f32x4*)(vo + 128 + 8 * i + 4) = (f32x4){f[4], f[5], f[6], f[7]}; }
            }
        }
        LAS unsigned* Vt32 = (LAS unsigned*)Vt;
#pragma unroll
        for (int i = 0; i < 2; ++i) {
            const unsigned aw[4] = {a[i].x, a[i].y, a[i].z, a[i].w}, bw[4] = {bb[i].x, bb[i].y, bb[i].z, bb[i].w};
#pragma unroll
            for (int j = 0; j < 4; ++j) { const int d = 16 * dq + 8 * i + 2 * j;
                Vt32[(d * 264 + key0) >> 1] = (aw[j] & 0xffffu) | (bw[j] << 16);
                Vt32[((d + 1) * 264 + key0) >> 1] = (aw[j] >> 16) | (bw[j] & 0xffff0000u); }
        }
    }
    __syncthreads();
    const int hidx = kvh * 8 + wave, ql = lane & 31, hh = lane >> 5;
    const float sink = p.sinks[hidx];
    for (int qt = 0; qt < 4; ++qt) {
        const int tokpos = n * 128 + 32 * qt + ql; const size_t row = rowbase + tokpos;
        const bf16_t* qrow = z + row * NIN + O_Q + hidx * 64;
        bf16x8 qf[4];
        {
            float x1[8], x2[8], r[8]; unpack8(*(const u32x4*)(qrow), x1); unpack8(*(const u32x4*)(qrow + 8), x2);
            const f32x4 c0 = *(const f32x4*)(rope + tokpos * 16), c1 = *(const f32x4*)(rope + tokpos * 16 + 4), s0 = *(const f32x4*)(rope + tokpos * 16 + 8), s1 = *(const f32x4*)(rope + tokpos * 16 + 12);
#pragma unroll
            for (int i = 0; i < 8; ++i) { const float c = i < 4 ? c0[i & 3] : c1[i & 3], s = i < 4 ? s0[i & 3] : s1[i & 3]; r[i] = hh == 0 ? x1[i] * c - x2[i] * s : x2[i] * c + x1[i] * s; }
            qf[0] = __builtin_bit_cast(bf16x8, pack8(r));
        }
#pragma unroll
        for (int ks = 1; ks < 4; ++ks) qf[ks] = *(const bf16x8*)(qrow + 16 * ks + 8 * hh);
        f32x16 s[5];
#pragma unroll
        for (int kt = 0; kt < 5; ++kt) {
#pragma unroll
            for (int i = 0; i < 16; ++i) s[kt][i] = 0.f;
#pragma unroll
            for (int ks = 0; ks < 4; ++ks) { const bf16x8 kf = *(const LAS bf16x8*)(Ks + (32 * (qt + kt) + ql) * 72 + 16 * ks + 8 * hh);
                s[kt] = __builtin_amdgcn_mfma_f32_32x32x16_bf16(kf, qf[ks], s[kt], 0, 0, 0); }
        }
        float mx = sink;
#pragma unroll
        for (int kt = 0; kt < 5; ++kt) {
            const bool dead = (n == 0) && (qt + kt < 4);
#pragma unroll
            for (int i = 0; i < 16; ++i) { const int keyrow = (i & 3) + 8 * (i >> 2) + 4 * hh;
                bool valid = !dead; if (kt == 0) valid = valid && (keyrow >= ql); if (kt == 4) valid = valid && (keyrow <= ql);
                const float v = valid ? s[kt][i] * 0.125f : -1e30f; s[kt][i] = v; mx = fmaxf(mx, v); }
        }
        mx = fmaxf(mx, __shfl_xor(mx, 32));
        const float mb = mx * LOG2E; float sum = 0.f;
#pragma unroll
        for (int kt = 0; kt < 5; ++kt)
#pragma unroll
            for (int i = 0; i < 16; ++i) { const float e = __builtin_amdgcn_exp2f(s[kt][i] * LOG2E - mb); s[kt][i] = e; sum += e; }
        sum += __shfl_xor(sum, 32); sum += __builtin_amdgcn_exp2f(sink * LOG2E - mb);
        const float inv = 1.0f / sum;
        f32x16 o[2];
#pragma unroll
        for (int dt = 0; dt < 2; ++dt)
#pragma unroll
            for (int i = 0; i < 16; ++i) o[dt][i] = 0.f;
#pragma unroll
        for (int kt = 0; kt < 5; ++kt)
#pragma unroll
            for (int ss = 0; ss < 2; ++ss) {
                u32x4 pw; pw.x = pk2(s[kt][8 * ss + 0], s[kt][8 * ss + 1]); pw.y = pk2(s[kt][8 * ss + 2], s[kt][8 * ss + 3]); pw.z = pk2(s[kt][8 * ss + 4], s[kt][8 * ss + 5]); pw.w = pk2(s[kt][8 * ss + 6], s[kt][8 * ss + 7]);
                const bf16x8 pf = __builtin_bit_cast(bf16x8, pw);
#pragma unroll
                for (int dt = 0; dt < 2; ++dt) { const LAS bf16_t* vb = Vt + (32 * dt + ql) * 264 + 32 * (qt + kt) + 16 * ss + 4 * hh;
                    const u32x2 lo = *(const LAS u32x2*)(vb), hi = *(const LAS u32x2*)(vb + 8);
                    const bf16x8 vf = __builtin_bit_cast(bf16x8, (u32x4){lo.x, lo.y, hi.x, hi.y});
                    o[dt] = __builtin_amdgcn_mfma_f32_32x32x16_bf16(vf, pf, o[dt], 0, 0, 0); }
            }
#pragma unroll
        for (int dt = 0; dt < 2; ++dt)
#pragma unroll
            for (int g4 = 0; g4 < 4; ++g4) { const int col = hidx * 64 + 32 * dt + 8 * g4 + 4 * hh;
                const u32x2 gw = *(const u32x2*)(z + row * NIN + O_GA + col);
                u32x2 w; w.x = pk2(o[dt][4 * g4 + 0] * inv * silu(bflo(gw.x)), o[dt][4 * g4 + 1] * inv * silu(bfhi(gw.x)));
                w.y = pk2(o[dt][4 * g4 + 2] * inv * silu(bflo(gw.y)), o[dt][4 * g4 + 3] * inv * silu(bfhi(gw.y)));
                *(u32x2*)(mixed + row * DM + DPOOL + col) = w; }
    }
}

__device__ __forceinline__ void sattn_item(const Params& p, LAS unsigned char* lds, int item) {
    const int tid = threadIdx.x, lane = tid & 63, wave = __builtin_amdgcn_readfirstlane(tid >> 6);
    const int b = item >> 1, kvh = item & 1, hidx = kvh * 8 + wave;
    const bf16_t* zs = (const bf16_t*)(p.ws + WS_Z) + (size_t)(MP + b) * NIN; const float* rope = (const float*)(p.ws + WS_ROPE) + 8192 * 16;
    bf16_t* mixed = (bf16_t*)(p.ws + WS_MIX);
    LAS float* Kf = (LAS float*)lds;
    LAS float* Vf = (LAS float*)(lds + 33552);
    LAS float* Qw = (LAS float*)(lds + 33552 + 33024);
    LAS float* Pw = Qw + 512;
    {
        const int j = tid >> 2, part = tid & 3;
        const size_t so = (((size_t)b * 128 + j) * 2 + kvh) * 64 + part * 16;
        f32x4 k4[4], v4[4];
#pragma unroll
        for (int i = 0; i < 4; ++i) { k4[i] = *(const f32x4*)(p.sk + so + 4 * i); v4[i] = *(const f32x4*)(p.sv + so + 4 * i); }
#pragma unroll
        for (int i = 0; i < 4; ++i) {
#pragma unroll
            for (int e = 0; e < 4; ++e) Kf[j * 65 + part * 16 + 4 * i + e] = k4[i][e];
            *(LAS f32x4*)(Vf + j * 64 + part * 16 + 4 * i) = v4[i]; }
        if (j >= 1) { const size_t oo = (((size_t)b * 128 + (j - 1)) * 2 + kvh) * 64 + part * 16;
#pragma unroll
            for (int i = 0; i < 4; ++i) { *(f32x4*)(p.out + OUT_KS + oo + 4 * i) = k4[i]; *(f32x4*)(p.out + OUT_VS + oo + 4 * i) = v4[i]; } }
    }
    const size_t onew = (((size_t)b * 128 + 127) * 2 + kvh) * 64;
    if (wave == 0) { const int d = lane; const float x = bf1(zs[O_K + kvh * 64 + d]); const float xp = __shfl_xor(x, 8);
        const float c = rope[d & 7], s = rope[8 + (d & 7)];
        const float r = d < 8 ? x * c - xp * s : (d < 16 ? x * c + xp * s : x);
        Kf[128 * 65 + d] = r; p.out[OUT_KS + onew + d] = r; }
    else if (wave == 1) { const int d = lane; const float v = bf1(zs[O_V + kvh * 64 + d]); Vf[128 * 64 + d] = v; p.out[OUT_VS + onew + d] = v; }
    { const int d = lane; const float x = bf1(zs[O_Q + hidx * 64 + d]); const float xp = __shfl_xor(x, 8);
      const float c = rope[d & 7], s = rope[8 + (d & 7)];
      const float r = d < 8 ? x * c - xp * s : (d < 16 ? x * c + xp * s : x);
      Qw[wave * 64 + d] = r * 0.125f; }
    __syncthreads();
    float s0 = 0.f, s1 = 0.f, s2 = 0.f;
#pragma unroll 8
    for (int d = 0; d < 64; ++d) { const float q = Qw[wave * 64 + d]; s0 += q * Kf[lane * 65 + d]; s1 += q * Kf[(lane + 64) * 65 + d]; s2 += q * Kf[128 * 65 + d]; }
    const float sink = p.sinks[hidx];
    const float m = fmaxf(fmaxf(wave_max(fmaxf(s0, s1)), s2), sink), mb = m * LOG2E;
    const float e0 = __builtin_amdgcn_exp2f(s0 * LOG2E - mb), e1 = __builtin_amdgcn_exp2f(s1 * LOG2E - mb), e2 = __builtin_amdgcn_exp2f(s2 * LOG2E - mb);
    const float sum = wave_sum(e0 + e1) + e2 + __builtin_amdgcn_exp2f(sink * LOG2E - mb);
    Pw[wave * 132 + lane] = e0; Pw[wave * 132 + 64 + lane] = e1; if (lane == 0) Pw[wave * 132 + 128] = e2;
    asm volatile("s_waitcnt lgkmcnt(0)" ::: "memory");
    float o = 0.f;
#pragma unroll 8
    for (int key = 0; key < 129; ++key) o += Pw[wave * 132 + key] * Vf[key * 64 + lane];
    const int col = hidx * 64 + lane;
    const float ga = bf1(zs[O_GA + col]);
    mixed[(size_t)(MP + b) * DM + DPOOL + col] = (bf16_t)(pk2(o / sum * silu(ga), 0.f) & 0xffffu);
}

__device__ __forceinline__ void spool_item(const Params& p, LAS unsigned char* lds, int item) {
    const int tid = threadIdx.x, lane = tid & 63, wave = __builtin_amdgcn_readfirstlane(tid >> 6);
    const int g = item >> 3, rg = item & 7, w = 2 << g;
    const bf16_t* z = (const bf16_t*)(p.ws + WS_Z); const bf16_t* wpool_t = (const bf16_t*)(p.ws + WS_WPOOL_T); bf16_t* mixed = (bf16_t*)(p.ws + WS_MIX);
    LAS bf16_t* As = (LAS bf16_t*)lds;
    {
        const int row = tid >> 5, c8 = (tid & 31) * 8, b = rg * 16 + row, c = g * 256 + c8;
        float sum[8], u[8];
#pragma unroll
        for (int j = 0; j < 8; ++j) sum[j] = 0.f;
        for (int i = 0; i < w - 1; ++i) { const float* sp = p.spool + ((size_t)b * 15 + (16 - w + i)) * DPOOL + c; const f32x4 a = *(const f32x4*)sp, bq = *(const f32x4*)(sp + 4);
#pragma unroll
            for (int j = 0; j < 4; ++j) { sum[j] += a[j]; sum[4 + j] += bq[j]; } }
        unpack8(*(const u32x4*)(z + (size_t)(MP + b) * NIN + O_U + c), u);
        const float rw = 1.0f / (float)w; float o[8];
#pragma unroll
        for (int j = 0; j < 8; ++j) o[j] = (sum[j] + u[j]) * rw - u[j];
        *(LAS u32x4*)(As + row * 264 + c8) = pack8(o);
    }
    __syncthreads();
    const int fr = lane & 15, fq = lane >> 4;
    f32x4 acc[2] = {(f32x4){0.f, 0.f, 0.f, 0.f}, (f32x4){0.f, 0.f, 0.f, 0.f}};
#pragma unroll
    for (int kk = 0; kk < 256; kk += 32) { const bf16x8 a = *(const LAS bf16x8*)(As + fr * 264 + kk + 8 * fq);
#pragma unroll
        for (int t = 0; t < 2; ++t) { const bf16x8 bf = *(const bf16x8*)(wpool_t + (size_t)(g * 256 + 32 * wave + 16 * t + fr) * 256 + kk + 8 * fq);
            acc[t] = __builtin_amdgcn_mfma_f32_16x16x32_bf16(a, bf, acc[t], 0, 0, 0); } }
#pragma unroll
    for (int t = 0; t < 2; ++t) { const int col = g * 256 + 32 * wave + 16 * t + fr; const float sc = p.pscale[col];
#pragma unroll
        for (int r = 0; r < 4; ++r) { const int b = rg * 16 + 4 * fq + r; const float gp = bf1(z[(size_t)(MP + b) * NIN + O_GP + col]);
            mixed[(size_t)(MP + b) * DM + col] = (bf16_t)(pk2(acc[t][r] * sc * silu(gp), 0.f) & 0xffffu); } }
}

__device__ __forceinline__ void phase2(const Params& p, LAS unsigned char* lds) {
    const int tid = threadIdx.x, c = blockIdx.x, G = gridDim.x;
    const bf16_t* z = (const bf16_t*)(p.ws + WS_Z); bf16_t* dpool = (bf16_t*)(p.ws + WS_D); bf16_t* mixed = (bf16_t*)(p.ws + WS_MIX);
    pg8::StaticOrder S; S.init(MP, DPOOL, G, c);
    { pg8::Unit u; for (int i = 0; S.next(i, u); ++i) pool_d_unit(z, dpool, u.pm, u.pn); }
    for (int it = c; it < 256; it += G) { attn_item(p, lds, it); __syncthreads(); }
    for (int it = c; it < 256; it += G) { sattn_item(p, lds, it); __syncthreads(); }
    for (int it = c; it < 32; it += G) { spool_item(p, lds, it); __syncthreads(); }
    for (int i = c * 512 + tid; i < MS * 15 * (DPOOL / 4); i += G * 512) { const int c4 = i & 255, r = (i >> 8) % 15, b = (i >> 8) / 15;
        f32x4 v;
        if (r < 14) v = *(const f32x4*)(p.spool + ((size_t)b * 15 + r + 1) * DPOOL + 4 * c4);
        else { const u32x2 w = *(const u32x2*)(z + (size_t)(MP + b) * NIN + O_U + 4 * c4); v = (f32x4){bflo(w.x), bfhi(w.x), bflo(w.y), bfhi(w.y)}; }
        *(f32x4*)(p.out + OUT_PS + ((size_t)b * 15 + r) * DPOOL + 4 * c4) = v; }
    for (int i = c * 512 + tid; i < NB * 15 * (DPOOL / 4); i += G * 512) { const int c4 = i & 255, r = (i >> 8) % 15, b = (i >> 8) / 15;
        const u32x2 w = *(const u32x2*)(z + ((size_t)b * SEQ + SEQ - 15 + r) * NIN + O_U + 4 * c4);
        *(f32x4*)(p.out + OUT_PP + ((size_t)b * 15 + r) * DPOOL + 4 * c4) = (f32x4){bflo(w.x), bfhi(w.x), bflo(w.y), bfhi(w.y)}; }
    asm volatile("s_waitcnt vmcnt(0)" ::: "memory"); __syncthreads();
    pg8::Gemm gm{dpool, (const bf16_t*)(p.ws + WS_WPOOL_T), MP, DPOOL, 256, DPOOL, 256, 256};
    EpiPool E{z, mixed, p.pscale};
    pg8::gemm_phase<EpiPool>(lds, gm, S, E);
}

__device__ __forceinline__ void sout_item(const Params& p, int item) {
    const int tid = threadIdx.x, lane = tid & 63, wave = __builtin_amdgcn_readfirstlane(tid >> 6), fr = lane & 15, fq = lane >> 4;
    const bf16_t* A = (const bf16_t*)(p.ws + WS_MIX) + (size_t)(MP + 16 * wave + fr) * DM + 8 * fq;
    const bf16_t* B = (const bf16_t*)(p.ws + WS_WOUT_T) + (size_t)(16 * item + fr) * DM + 8 * fq;
    f32x4 acc = (f32x4){0.f, 0.f, 0.f, 0.f};
#pragma unroll 8
    for (int kk = 0; kk < DM; kk += 32) acc = __builtin_amdgcn_mfma_f32_16x16x32_bf16(*(const bf16x8*)(A + kk), *(const bf16x8*)(B + kk), acc, 0, 0, 0);
    float* parts = (float*)(p.ws + WS_PARTS);
#pragma unroll
    for (int r = 0; r < 4; ++r) { const int row = 16 * wave + 4 * fq + r, col = 16 * item + fr;
        const float v = acc[r] + p.xs[(size_t)row * DM + col]; p.out[OUT_YS + (size_t)row * DM + col] = v;
        float ss = v * v; ss += __shfl_xor(ss, 1); ss += __shfl_xor(ss, 2); ss += __shfl_xor(ss, 4); ss += __shfl_xor(ss, 8);
        if (fr == 0) parts[row * 128 + item] = ss; }
}

__device__ __forceinline__ void phase4(const Params& p) {
    const int tid = threadIdx.x, lane = tid & 63, wave = tid >> 6, gw = blockIdx.x * 8 + wave, NGW = gridDim.x * 8;
    const float* part = (const float*)(p.ws + WS_PART); const float* parts = (const float*)(p.ws + WS_PARTS);
    for (int m = gw; m < MTOT; m += NGW) {
        float ss;
        if (m < MP) ss = lane < 32 ? part[(size_t)m * 32 + lane] : 0.f; else ss = parts[(m - MP) * 128 + lane] + parts[(m - MP) * 128 + 64 + lane];
        const float rstd = 1.0f / sqrtf(wave_sum(ss) * (1.0f / DM) + EPS);
        f32x4* y = (f32x4*)(p.out + (size_t)m * DM);
        f32x4 v[8];
#pragma unroll
        for (int j = 0; j < 8; ++j) v[j] = y[64 * j + lane];
#pragma unroll
        for (int j = 0; j < 8; ++j) { const f32x4 g4 = ((const f32x4*)p.fnorm_g)[64 * j + lane]; y[64 * j + lane] = v[j] * rstd * g4; }
    }
}

__global__ void __launch_bounds__(512, 2) fwd_megakernel(Params p) {
    extern __shared__ __attribute__((aligned(16))) unsigned char lds_raw[];
    LAS unsigned char* lds = (LAS unsigned char*)lds_raw;
    cg::grid_group grid = cg::this_grid();
    const int lo = p.ph_lo, hi = p.ph_hi;
#define IN(k) (lo <= (k) && (k) < hi)
#define BOTH(k) (IN(k) && IN((k) + 1))
    if (IN(0)) { phase0(p, lds); if (BOTH(0)) grid.sync(); }
    if (IN(1)) {
        pg8::Gemm gm{(const bf16_t*)(p.ws + WS_H), (const bf16_t*)(p.ws + WS_WIN_T), MPAD, NIN, DM, DM, DM, 0};
        pg8::StaticOrder S; S.init(MPAD, NIN, gridDim.x, blockIdx.x);
        EpiZ E{(bf16_t*)(p.ws + WS_Z)};
        pg8::gemm_phase<EpiZ>(lds, gm, S, E);
        if (BOTH(1)) grid.sync();
    }
    if (IN(2)) { phase2(p, lds); if (BOTH(2)) grid.sync(); }
    if (IN(3)) {
        pg8::Gemm gm{(const bf16_t*)(p.ws + WS_MIX), (const bf16_t*)(p.ws + WS_WOUT_T), MP, DM, DM, DM, DM, 0};
        pg8::StaticOrder S; S.init(MP, DM, gridDim.x, blockIdx.x);
        EpiOut E{p.xp, p.out + OUT_YP, (float*)(p.ws + WS_PART)};
        pg8::gemm_phase<EpiOut>(lds, gm, S, E);
        for (int it = blockIdx.x; it < 128; it += gridDim.x) sout_item(p, it);
        if (BOTH(3)) grid.sync();
    }
    if (IN(4)) phase4(p);
#undef IN
#undef BOTH
}

extern "C" void kernel_launch(void* const* d_in, const int* in_sizes, int n_in, void* d_out, int out_size, void* d_ws, size_t ws_size, hipStream_t stream) {
    static int grid = 0;
    if (grid == 0) {
        if (n_in != 12 || ws_size < WS_END) { fprintf(stderr, "kernel_launch: unexpected n_in %d / ws_size %zu (need %zu)\n", n_in, ws_size, (size_t)WS_END); grid = -1; return; }
        int dev = 0, cus = 0, per_cu = 0;
        hipGetDevice(&dev); hipDeviceGetAttribute(&cus, hipDeviceAttributeMultiprocessorCount, dev);
        if (hipFuncSetAttribute((const void*)fwd_megakernel, hipFuncAttributeMaxDynamicSharedMemorySize, LDS_BYTES) != hipSuccess) { fprintf(stderr, "kernel_launch: hipFuncSetAttribute failed\n"); grid = -1; return; }
        if (hipOccupancyMaxActiveBlocksPerMultiprocessor(&per_cu, (const void*)fwd_megakernel, 512, LDS_BYTES) != hipSuccess || per_cu < 1) { fprintf(stderr, "kernel_launch: occupancy query says %d\n", per_cu); per_cu = 1; }
        (void)hipGetLastError();
        grid = cus;
    }
    if (grid < 0) return;
    Params p{};
    p.xp = (const float*)d_in[0]; p.xs = (const float*)d_in[1]; p.spool = (const float*)d_in[2]; p.sk = (const float*)d_in[3]; p.sv = (const float*)d_in[4];
    p.norm_g = (const float*)d_in[5]; p.w_in = (const float*)d_in[6]; p.w_pool = (const float*)d_in[7]; p.pscale = (const float*)d_in[8]; p.sinks = (const float*)d_in[9];
    p.w_out = (const float*)d_in[10]; p.fnorm_g = (const float*)d_in[11]; p.out = (float*)d_out; p.ws = (unsigned char*)d_ws;
#if MK_N_LAUNCHES == 1
    p.ph_lo = 0; p.ph_hi = 5;
    void* args[] = {&p};
    hipError_t e = hipLaunchCooperativeKernel((const void*)fwd_megakernel, dim3(grid), dim3(512), args, LDS_BYTES, stream);
    if (e != hipSuccess) fprintf(stderr, "cooperative launch failed: %s (grid %d)\n", hipGetErrorString(e), grid);
#else
    for (int ph = 0; ph < 5; ++ph) { p.ph_lo = ph; p.ph_hi = ph + 1; hipLaunchKernelGGL(fwd_megakernel, dim3(grid), dim3(512), LDS_BYTES, stream, p); }
#endif
}
```
